# Optimizing an MI355X kernel written in HIP

```python
import jax, jax.numpy as jnp
from jax import lax
import numpy as np

D_MODEL = 1024
BATCH = 4
SEQ = 4096
DEPTH = 1

CHUNK = 64
Q_BLOCK = 128
MLA_HEADS = 8
QK_NOPE_DIM = 64
QK_ROPE_DIM = 32
V_HEAD_DIM = 64
Q_LORA_RANK = 384
KV_LORA_RANK = 256
ROPE_THETA = 10000.0
MLA_WIDTH = MLA_HEADS * V_HEAD_DIM
CONV_DIM = D_MODEL - MLA_WIDTH
CONV_WIDTH = 3
IN_PROJ_DIM = Q_LORA_RANK + KV_LORA_RANK + QK_ROPE_DIM + 3 * CONV_DIM
N_EXPERTS = 256
TOP_K = 8
N_EXPERT_GROUPS = 8
TOPK_GROUPS = 4
EXPERT_DIM = 256
SHARED_DIM = 256
ROUTED_SCALE = 2.5
EXPERT_BLOCK = 128
EPS = 1e-6

kernel_name = "hybrid_mla_shortconv_moe_block"


def rms_norm(x, g):
    xf = x.astype(jnp.float32)
    y = xf * lax.rsqrt(jnp.mean(xf * xf, axis=-1, keepdims=True) + EPS)
    return (y * g.astype(jnp.float32)).astype(x.dtype)


def rope_tables(positions):
    inv = 1.0 / (ROPE_THETA ** (jnp.arange(0, QK_ROPE_DIM, 2, dtype=jnp.float32) / QK_ROPE_DIM))
    ang = positions.astype(jnp.float32)[..., None] * inv
    return jnp.cos(ang), jnp.sin(ang)


def apply_rope(x, cos, sin):
    xf = x.astype(jnp.float32)
    x1, x2 = jnp.split(xf, 2, axis=-1)
    return jnp.concatenate([x1 * cos - x2 * sin, x1 * sin + x2 * cos], axis=-1).astype(x.dtype)


def chunk_causal_attention(q, k, v):
    B, S, H, Dqk = q.shape
    Dv = v.shape[-1]
    nq = S // Q_BLOCK
    scale = Dqk ** -0.5
    qb = q.reshape(B, nq, Q_BLOCK, H, Dqk).transpose(1, 0, 3, 2, 4)
    kh = k.transpose(0, 2, 1, 3)
    vh = v.transpose(0, 2, 1, 3)
    k_chunk = jnp.arange(S) // CHUNK

    def block(args):
        q_blk, bi = args
        s = jnp.einsum('bhqd,bhkd->bhqk', q_blk, kh).astype(jnp.float32) * scale
        q_chunk = (bi * Q_BLOCK + jnp.arange(Q_BLOCK)) // CHUNK
        s = jnp.where(k_chunk[None, :] <= q_chunk[:, None], s, -jnp.inf)
        p = jax.nn.softmax(s, axis=-1).astype(vh.dtype)
        return jnp.einsum('bhqk,bhkd->bhqd', p, vh)

    o = lax.map(block, (qb, jnp.arange(nq)))
    return o.transpose(1, 0, 3, 2, 4).reshape(B, S, H * Dv)


def token_mixers(h, positions, w_in, g_q_lat, w_uq, g_kv_lat, w_ukv, w_conv,
                 g_attn_out, g_conv_out, w_out):
    B, S, _ = h.shape
    z = h @ w_in
    cuts = [Q_LORA_RANK,
            Q_LORA_RANK + KV_LORA_RANK,
            Q_LORA_RANK + KV_LORA_RANK + QK_ROPE_DIM,
            Q_LORA_RANK + KV_LORA_RANK + QK_ROPE_DIM + CONV_DIM,
            Q_LORA_RANK + KV_LORA_RANK + QK_ROPE_DIM + 2 * CONV_DIM]
    c_q, c_kv, k_rope, gate_b, gate_c, xv = jnp.split(z, cuts, axis=-1)

    q = (rms_norm(c_q, g_q_lat) @ w_uq).reshape(B, S, MLA_HEADS, QK_NOPE_DIM + QK_ROPE_DIM)
    q_nope, q_rope = q[..., :QK_NOPE_DIM], q[..., QK_NOPE_DIM:]
    kv = (rms_norm(c_kv, g_kv_lat) @ w_ukv).reshape(B, S, MLA_HEADS, QK_NOPE_DIM + V_HEAD_DIM)
    k_nope, v = kv[..., :QK_NOPE_DIM], kv[..., QK_NOPE_DIM:]
    cos, sin = rope_tables(positions)
    q_rope = apply_rope(q_rope, cos[:, :, None, :], sin[:, :, None, :])
    k_rope = apply_rope(k_rope, cos, sin)
    q_full = jnp.concatenate([q_nope, q_rope], axis=-1)
    k_full = jnp.concatenate(
        [k_nope, jnp.broadcast_to(k_rope[:, :, None, :], (B, S, MLA_HEADS, QK_ROPE_DIM))], axis=-1)
    attn = chunk_causal_attention(q_full, k_full, v)

    u = gate_c * xv
    conv = lax.conv_general_dilated(
        u, w_conv[:, None, :].astype(u.dtype), window_strides=(1,),
        padding=[(CONV_WIDTH - 1, 0)], dimension_numbers=('NWC', 'WIO', 'NWC'),
        feature_group_count=CONV_DIM)
    y_conv = gate_b * conv

    mixed = jnp.concatenate([rms_norm(attn, g_attn_out), rms_norm(y_conv, g_conv_out)], axis=-1)
    return mixed @ w_out


def swiglu(h, wg, wu, wd):
    return (jax.nn.silu(h @ wg) * (h @ wu)) @ wd


def moe(h, w_router, b_router, w_gate, w_up, w_down, w_sh_gate, w_sh_up, w_sh_down):
    T, D = h.shape
    scores = jax.nn.sigmoid(h.astype(jnp.float32) @ w_router.astype(jnp.float32))
    sel = (scores + b_router.astype(jnp.float32)).reshape(T, N_EXPERT_GROUPS, N_EXPERTS // N_EXPERT_GROUPS)
    grp_score = lax.top_k(sel, 2)[0].sum(-1)
    _, top_g = lax.top_k(grp_score, TOPK_GROUPS)
    gmask = jax.nn.one_hot(top_g, N_EXPERT_GROUPS, dtype=jnp.float32).sum(1) > 0
    sel = jnp.where(gmask[:, :, None], sel, -jnp.inf).reshape(T, N_EXPERTS)
    _, idx = lax.top_k(sel, TOP_K)
    wts = jnp.take_along_axis(scores, idx, axis=1)
    wts = wts / jnp.sum(wts, axis=-1, keepdims=True) * ROUTED_SCALE

    M = T * TOP_K
    NB = (M + N_EXPERTS * (EXPERT_BLOCK - 1) + EXPERT_BLOCK - 1) // EXPERT_BLOCK
    P = NB * EXPERT_BLOCK
    flat_e = idx.reshape(-1)
    flat_tok = jnp.repeat(jnp.arange(T, dtype=jnp.int32), TOP_K)
    flat_w = wts.reshape(-1)
    order = jnp.argsort(flat_e)
    sorted_e = flat_e[order]
    counts = jnp.bincount(flat_e, length=N_EXPERTS)
    padded = ((counts + EXPERT_BLOCK - 1) // EXPERT_BLOCK) * EXPERT_BLOCK
    pad_end = jnp.cumsum(padded)
    pad_start = pad_end - padded
    start = jnp.cumsum(counts) - counts
    dest = pad_start[sorted_e] + (jnp.arange(M) - start[sorted_e])
    buf_tok = jnp.zeros((P,), jnp.int32).at[dest].set(flat_tok[order])
    buf_w = jnp.zeros((P,), jnp.float32).at[dest].set(flat_w[order])
    blk_exp = jnp.minimum(
        jnp.searchsorted(pad_end, jnp.arange(NB) * EXPERT_BLOCK, side='right'), N_EXPERTS - 1)

    def expert_block(args):
        tok, e, wt = args
        xb = h[tok]
        y = swiglu(xb, w_gate[e], w_up[e], w_down[e])
        return y * wt[:, None].astype(y.dtype)

    ys = lax.map(expert_block, (buf_tok.reshape(NB, EXPERT_BLOCK), blk_exp,
                                buf_w.reshape(NB, EXPERT_BLOCK)))
    routed = jax.ops.segment_sum(ys.reshape(P, D), buf_tok, num_segments=T)
    return routed + swiglu(h, w_sh_gate, w_sh_up, w_sh_down)


def setup_inputs(seed: int = 0) -> dict:
    key = jax.random.key(seed)
    ks = jax.random.split(key, 32)
    f32 = jnp.float32

    def nrm(k, shape, scale):
        return jax.random.normal(k, shape, f32) * scale

    def gain(k, n):
        return 1.0 + 0.05 * jax.random.normal(k, (DEPTH, n), f32)

    D = D_MODEL
    offsets = jax.random.randint(ks[2], (BATCH, 1), 0, 4096, dtype=jnp.int32)
    positions = offsets + jnp.arange(SEQ, dtype=jnp.int32)[None, :]
    return {
        "x": nrm(ks[0], (BATCH, SEQ, D), 1.0),
        "c": nrm(ks[1], (BATCH, D), 1.0),
        "positions": positions,
        "w_ada": nrm(ks[3], (DEPTH, D, 6 * D), 0.5 * D ** -0.5),
        "b_ada": nrm(ks[4], (DEPTH, 6 * D), 0.01),
        "g_pre_mix": gain(ks[5], D),
        "w_in": nrm(ks[6], (DEPTH, D, IN_PROJ_DIM), D ** -0.5),
        "g_q_lat": gain(ks[7], Q_LORA_RANK),
        "w_uq": nrm(ks[8], (DEPTH, Q_LORA_RANK, MLA_HEADS * (QK_NOPE_DIM + QK_ROPE_DIM)), Q_LORA_RANK ** -0.5),
        "g_kv_lat": gain(ks[9], KV_LORA_RANK),
        "w_ukv": nrm(ks[10], (DEPTH, KV_LORA_RANK, MLA_HEADS * (QK_NOPE_DIM + V_HEAD_DIM)), KV_LORA_RANK ** -0.5),
        "w_conv": nrm(ks[11], (DEPTH, CONV_WIDTH, CONV_DIM), CONV_WIDTH ** -0.5),
        "g_attn_out": gain(ks[12], MLA_WIDTH),
        "g_conv_out": gain(ks[13], CONV_DIM),
        "w_out": nrm(ks[14], (DEPTH, D, D), D ** -0.5),
        "g_post_mix": gain(ks[15], D),
        "g_pre_ffn": gain(ks[16], D),
        "w_router": nrm(ks[17], (DEPTH, D, N_EXPERTS), D ** -0.5),
        "b_router": nrm(ks[18], (DEPTH, N_EXPERTS), 0.01),
        "w_gate": nrm(ks[19], (DEPTH, N_EXPERTS, D, EXPERT_DIM), D ** -0.5),
        "w_up": nrm(ks[20], (DEPTH, N_EXPERTS, D, EXPERT_DIM), D ** -0.5),
        "w_down": nrm(ks[21], (DEPTH, N_EXPERTS, EXPERT_DIM, D), EXPERT_DIM ** -0.5),
        "w_sh_gate": nrm(ks[22], (DEPTH, D, SHARED_DIM), D ** -0.5),
        "w_sh_up": nrm(ks[23], (DEPTH, D, SHARED_DIM), D ** -0.5),
        "w_sh_down": nrm(ks[24], (DEPTH, SHARED_DIM, D), SHARED_DIM ** -0.5),
        "g_post_ffn": gain(ks[25], D),
    }


def reference(x, c, positions, w_ada, b_ada, g_pre_mix, w_in, g_q_lat, w_uq, g_kv_lat, w_ukv,
              w_conv, g_attn_out, g_conv_out, w_out, g_post_mix, g_pre_ffn, w_router, b_router,
              w_gate, w_up, w_down, w_sh_gate, w_sh_up, w_sh_down, g_post_ffn):
    B, S, D = x.shape
    for l in range(DEPTH):
        mod = jax.nn.silu(c) @ w_ada[l] + b_ada[l]
        sh1, sc1, g1, sh2, sc2, g2 = [m[:, None, :] for m in jnp.split(mod, 6, axis=-1)]
        h = rms_norm(x, g_pre_mix[l]) * (1.0 + sc1) + sh1
        mix = token_mixers(h, positions, w_in[l], g_q_lat[l], w_uq[l], g_kv_lat[l], w_ukv[l],
                           w_conv[l], g_attn_out[l], g_conv_out[l], w_out[l])
        x = x + g1 * rms_norm(mix, g_post_mix[l])
        h = rms_norm(x, g_pre_ffn[l]) * (1.0 + sc2) + sh2
        f = moe(h.reshape(B * S, D), w_router[l], b_router[l], w_gate[l], w_up[l], w_down[l],
                w_sh_gate[l], w_sh_up[l], w_sh_down[l]).reshape(B, S, D)
        x = x + g2 * rms_norm(f, g_post_ffn[l])
    return x
```

```cpp
#include <hip/hip_runtime.h>
#include <cstdio>
#include <cstdint>

typedef unsigned short bf16;
__device__ __forceinline__ bf16 f2bf(float f) { unsigned u = __builtin_bit_cast(unsigned, f); return (bf16)((u + 0x7fffu + ((u >> 16) & 1u)) >> 16); }
__device__ __forceinline__ float bf2f(bf16 b) { return __builtin_bit_cast(float, (unsigned)b << 16); }

constexpr int NB = 4, S = 4096, D = 1024, T = NB * S;
constexpr int NH = 8, DN = 64, DR = 32, DQK = 96, DV = 64;
constexpr int QL = 384, KVL = 256, CD = 512, INP = 2208, ZLD = 2304;
constexpr int ZQ = 0, ZKV = 384, ZKR = 640, ZGB = 672, ZGC = 1184, ZXV = 1696;
constexpr int NE = 256, TOPK = 8, NG = 8, GSZ = 32, TOPG = 4, ED = 256;
constexpr float EPS = 1e-6f, RSCALE = 2.5f;
constexpr int LCAP = T;

constexpr size_t MiB = 1u << 20;
constexpr size_t WS_CTL = 0;
constexpr size_t WS_MOD = 1 * MiB;
constexpr size_t WS_BASE = WS_MOD + 128 * 1024;
constexpr size_t WS_RQ = 2 * MiB;
constexpr size_t WS_SSA = 3 * MiB;
constexpr size_t WS_H1 = 4 * MiB;
constexpr size_t WS_Z = 36 * MiB;
constexpr size_t WS_Q = 108 * MiB;
constexpr size_t WS_K = 132 * MiB;
constexpr size_t WS_VT = 156 * MiB;
constexpr size_t WS_MIX = 172 * MiB;
constexpr size_t WS_H2 = 204 * MiB;
constexpr size_t WS_H2LO = 236 * MiB;
constexpr size_t WS_LOG = 268 * MiB;
constexpr size_t WS_LTOK = 284 * MiB;
constexpr size_t WS_WTS = 300 * MiB;
constexpr size_t WS_ACT = 301 * MiB;
constexpr size_t WS_ACTSH = 365 * MiB;
constexpr size_t WS_Y = 373 * MiB;
constexpr size_t WS_TMP = 629 * MiB;
constexpr size_t WS_END = 693 * MiB;

struct P {
    const float *x, *c; const int* pos;
    const float *w_ada, *b_ada, *g_pre_mix, *w_in, *g_q_lat, *w_uq, *g_kv_lat, *w_ukv, *w_conv, *g_attn_out, *g_conv_out, *w_out,
        *g_post_mix, *g_pre_ffn, *w_router, *b_router, *w_gate, *w_up, *w_down, *w_sh_gate, *w_sh_up, *w_sh_down, *g_post_ffn;
    float* out; unsigned char* ws;
};
#define WSP(type, off) ((type*)(p.ws + (off)))

__device__ __forceinline__ float silu(float v) { return v / (1.f + __expf(-v)); }
__device__ __forceinline__ float block_sum(float v, float* red) {
    for (int o = 32; o > 0; o >>= 1) v += __shfl_xor(v, o);
    __syncthreads();
    if ((threadIdx.x & 63) == 0) red[threadIdx.x >> 6] = v;
    __syncthreads();
    float s = 0.f; for (int i = 0; i < (int)(blockDim.x >> 6); ++i) s += red[i];
    return s;
}

__global__ void k_mod(P p) {
    const int j = blockIdx.x * 256 + threadIdx.x, b = blockIdx.y;
    float acc = p.b_ada[j];
    for (int k = 0; k < D; ++k) acc += silu(p.c[b * D + k]) * p.w_ada[(size_t)k * 6 * D + j];
    WSP(float, WS_MOD)[b * 6 * D + j] = acc;
}
__global__ void k_h1(P p) {
    __shared__ float red[4];
    const int t = blockIdx.x, b = t / S; const float* xr = p.x + (size_t)t * D; const float* mod = WSP(float, WS_MOD) + b * 6 * D;
    float v[4], ss = 0.f;
    for (int i = 0; i < 4; ++i) { v[i] = xr[threadIdx.x + 256 * i]; ss += v[i] * v[i]; }
    ss = block_sum(ss, red);
    const float r = rsqrtf(ss / D + EPS);
    for (int i = 0; i < 4; ++i) { const int k = threadIdx.x + 256 * i;
        WSP(bf16, WS_H1)[(size_t)t * D + k] = f2bf(v[i] * r * p.g_pre_mix[k] * (1.f + mod[D + k]) + mod[k]); }
}
template <int NBM, class AL, class BL, class EP>
__global__ void __launch_bounds__(256) ngemm(int N, int K, AL al, BL bl, EP ep) {
    __shared__ float As[16][65], Bs[NBM][16][65];
    const int g = blockIdx.z, M = al.rows(g), m0 = blockIdx.y * 64, n0 = blockIdx.x * 64;
    if (m0 >= M) return;
    const int tx = threadIdx.x & 15, ty = threadIdx.x >> 4;
    float acc[NBM][4][4] = {};
    for (int k0 = 0; k0 < K; k0 += 16) {
        for (int i = threadIdx.x; i < 64 * 16; i += 256) { const int mm = i >> 4, kk = i & 15; As[kk][mm] = (m0 + mm < M) ? al(g, m0 + mm, k0 + kk) : 0.f; }
        for (int w = 0; w < NBM; ++w)
            for (int i = threadIdx.x; i < 64 * 16; i += 256) { const int kk = i >> 6, nn = i & 63; Bs[w][kk][nn] = (n0 + nn < N) ? bl(g, k0 + kk, n0 + nn, w) : 0.f; }
        __syncthreads();
#pragma unroll
        for (int kk = 0; kk < 16; ++kk) {
            float a[4]; for (int i = 0; i < 4; ++i) a[i] = As[kk][ty * 4 + i];
            for (int w = 0; w < NBM; ++w) { float b[4]; for (int j = 0; j < 4; ++j) b[j] = Bs[w][kk][tx * 4 + j];
                for (int i = 0; i < 4; ++i) for (int j = 0; j < 4; ++j) acc[w][i][j] += a[i] * b[j]; }
        }
        __syncthreads();
    }
    for (int i = 0; i < 4; ++i) for (int j = 0; j < 4; ++j) { const int m = m0 + ty * 4 + i, n = n0 + tx * 4 + j;
        if (m < M && n < N) { if (NBM == 1) ep(g, m, n, acc[0][i][j], 0.f); else ep(g, m, n, acc[0][i][j], acc[NBM - 1][i][j]); } }
}
struct AL_bf16 { const bf16* A; int lda, M; __device__ int rows(int) const { return M; } __device__ float operator()(int, int m, int k) const { return bf2f(A[(size_t)m * lda + k]); } };
struct BL_f32 { const float* B; int ldb, pad; __device__ float operator()(int, int k, int n, int) const { return B[(size_t)k * ldb + n]; } };
struct EP_z { bf16* Z; __device__ void operator()(int, int m, int n, float a, float) const { Z[(size_t)m * ZLD + n] = f2bf(a); } };
struct EP_f32 { float* C; int ldc, pad; __device__ void operator()(int, int m, int n, float a, float) const { C[(size_t)m * ldc + n] = a; } };
struct AL_lat { const bf16* Z; const float* gain; int col0, pad; __device__ int rows(int) const { return T; }
    __device__ float operator()(int, int m, int k) const { return bf2f(Z[(size_t)m * ZLD + col0 + k]) * gain[k]; } };

__global__ void k_prep(P p) {
    __shared__ float red[4];
    const int t = blockIdx.x, s = t % S, tid = threadIdx.x; const bf16* Z = WSP(bf16, WS_Z);
    const bf16* z = Z + (size_t)t * ZLD;
    float a = 0.f; for (int k = tid; k < QL; k += 256) { float v = bf2f(z[ZQ + k]); a += v * v; }
    a = block_sum(a, red); if (tid == 0) WSP(float, WS_RQ)[t] = rsqrtf(a / QL + EPS);
    float v = bf2f(z[ZKV + tid]); a = block_sum(v * v, red); if (tid == 0) WSP(float, WS_RQ + 65536)[t] = rsqrtf(a / KVL + EPS);
    float y[2], ss = 0.f;
    for (int i = 0; i < 2; ++i) { const int c = tid + 256 * i; float cv = 0.f;
        for (int j = 0; j < 3; ++j) { const int sj = s - 2 + j; if (sj >= 0) { const bf16* zz = Z + (size_t)(t - 2 + j) * ZLD; cv += p.w_conv[j * CD + c] * (bf2f(zz[ZGC + c]) * bf2f(zz[ZXV + c])); } }
        y[i] = bf2f(z[ZGB + c]) * cv; ss += y[i] * y[i]; }
    ss = block_sum(ss, red); const float r = rsqrtf(ss / CD + EPS);
    for (int i = 0; i < 2; ++i) { const int c = tid + 256 * i; WSP(bf16, WS_MIX)[(size_t)t * D + CD + c] = f2bf(y[i] * r * p.g_conv_out[c]); }
}
__device__ __forceinline__ void rope_cs(int pos, int i, float& cs, float& sn) {
    const float inv = 1.0f / powf(10000.0f, (float)(2 * i) / (float)DR); const float ang = (float)pos * inv; cs = cosf(ang); sn = sinf(ang);
}
__global__ void k_qfin(P p) {
    const int t = blockIdx.x, b = t / S, s = t % S; const float* q = WSP(float, WS_TMP) + (size_t)t * 768; const float rq = WSP(float, WS_RQ)[t];
    const float qs = 0.10206207261596575f * 1.4426950408889634f;
    const int pos = p.pos[t];
    for (int o = threadIdx.x; o < 768; o += 256) { const int h = o / DQK, d = o % DQK; float v;
        if (d < DN) v = q[o] * rq;
        else { const int i = (d - DN) & 15; float cs, sn; rope_cs(pos, i, cs, sn); const float x1 = q[h * DQK + DN + i] * rq, x2 = q[h * DQK + DN + 16 + i] * rq;
            v = (d - DN < 16) ? x1 * cs - x2 * sn : x1 * sn + x2 * cs; }
        WSP(bf16, WS_Q)[(((size_t)b * NH + h) * S + s) * DQK + d] = f2bf(v * qs); }
}
__global__ void k_kvfin(P p) {
    const int t = blockIdx.x, b = t / S, s = t % S; const float* kv = WSP(float, WS_TMP) + (size_t)t * 1024; const float r = WSP(float, WS_RQ + 65536)[t];
    const int pos = p.pos[t]; const bf16* z = WSP(bf16, WS_Z) + (size_t)t * ZLD;
    for (int o = threadIdx.x; o < 1024; o += 256) { const int h = o / 128, d = o % 128; const float v = kv[o] * r;
        if (d < DN) WSP(bf16, WS_K)[(((size_t)b * NH + h) * S + s) * DQK + d] = f2bf(v);
        else WSP(bf16, WS_VT)[(((size_t)b * NH + h) * DV + (d - DN)) * S + s] = f2bf(v); }
    { const int h = threadIdx.x >> 5, d = threadIdx.x & 31, i = d & 15; float cs, sn; rope_cs(pos, i, cs, sn);
      const float x1 = bf2f(z[ZKR + i]), x2 = bf2f(z[ZKR + 16 + i]); const float v = d < 16 ? x1 * cs - x2 * sn : x1 * sn + x2 * cs;
      WSP(bf16, WS_K)[(((size_t)b * NH + h) * S + s) * DQK + DN + d] = f2bf(v); }
}
__global__ void __launch_bounds__(64) k_attn(P p) {
    __shared__ float Ks[64][DQK + 1], Vs[64][DV + 1];
    const int qc = blockIdx.x, h = blockIdx.y, b = blockIdx.z, tid = threadIdx.x;
    const size_t bh = (size_t)b * NH + h; const int s = qc * 64 + tid;
    const bf16* Q = WSP(bf16, WS_Q) + (bh * S + s) * DQK; const bf16* Kb = WSP(bf16, WS_K) + bh * S * DQK; const bf16* VT = WSP(bf16, WS_VT) + bh * DV * S;
    float q[DQK], o[DV];
#pragma unroll
    for (int d = 0; d < DQK; ++d) q[d] = bf2f(Q[d]);
#pragma unroll
    for (int d = 0; d < DV; ++d) o[d] = 0.f;
    float m = -1e30f, l = 0.f;
    for (int kt = 0; kt <= qc; ++kt) {
        __syncthreads();
        for (int i = tid; i < 64 * DQK; i += 64) Ks[i / DQK][i % DQK] = bf2f(Kb[(size_t)(kt * 64) * DQK + i]);
        for (int i = tid; i < 64 * DV; i += 64) { const int d = i >> 6, kk = i & 63; Vs[kk][d] = bf2f(VT[(size_t)d * S + kt * 64 + kk]); }
        __syncthreads();
        for (int kk = 0; kk < 64; ++kk) { float sc = 0.f;
#pragma unroll
            for (int d = 0; d < DQK; ++d) sc += q[d] * Ks[kk][d];
            const float mn = fmaxf(m, sc), al = exp2f(m - mn), pe = exp2f(sc - mn); l = l * al + pe; m = mn;
#pragma unroll
            for (int d = 0; d < DV; ++d) o[d] = o[d] * al + pe * Vs[kk][d]; }
    }
    const int t = b * S + s; float ss = 0.f;
#pragma unroll
    for (int d = 0; d < DV; ++d) { const float v = o[d] / l; const bf16 hb = f2bf(v); WSP(bf16, WS_MIX)[(size_t)t * D + h * DV + d] = hb; const float vr = bf2f(hb); ss += vr * vr; }
    WSP(float, WS_SSA)[t * 8 + h] = ss;
}
struct AL_mix { const bf16* A; const float* ssa; const float* gain; __device__ int rows(int) const { return T; }
    __device__ float operator()(int, int m, int k) const { float v = bf2f(A[(size_t)m * D + k]);
        if (k < CD) { float ss = 0.f; for (int h = 0; h < 8; ++h) ss += ssa[m * 8 + h]; v *= rsqrtf(ss / CD + EPS) * gain[k]; } return v; } };
__global__ void k_post(P p) {
    __shared__ float red[4];
    const int t = blockIdx.x, b = t / S; const float* mx = WSP(float, WS_TMP) + (size_t)t * D; const float* mod = WSP(float, WS_MOD) + b * 6 * D;
    float v[4], ss = 0.f; for (int i = 0; i < 4; ++i) { v[i] = mx[threadIdx.x + 256 * i]; ss += v[i] * v[i]; }
    ss = block_sum(ss, red); float r = rsqrtf(ss / D + EPS); float x1[4]; ss = 0.f;
    for (int i = 0; i < 4; ++i) { const int k = threadIdx.x + 256 * i; x1[i] = p.x[(size_t)t * D + k] + mod[2 * D + k] * (v[i] * r * p.g_post_mix[k]); ss += x1[i] * x1[i]; p.out[(size_t)t * D + k] = x1[i]; }
    ss = block_sum(ss, red); r = rsqrtf(ss / D + EPS);
    for (int i = 0; i < 4; ++i) { const int k = threadIdx.x + 256 * i; const float h = x1[i] * r * p.g_pre_ffn[k] * (1.f + mod[4 * D + k]) + mod[3 * D + k];
        const bf16 hi = f2bf(h); WSP(bf16, WS_H2)[(size_t)t * D + k] = hi; WSP(bf16, WS_H2LO)[(size_t)t * D + k] = f2bf(h - bf2f(hi)); }
}
struct AL_h2full { const bf16 *hi, *lo; __device__ int rows(int) const { return T; } __device__ float operator()(int, int m, int k) const { return bf2f(hi[(size_t)m * D + k]) + bf2f(lo[(size_t)m * D + k]); } };
__global__ void k_route(P p) {
    const int t = blockIdx.x * 256 + threadIdx.x; if (t >= T) return;
    const float* lg = WSP(float, WS_LOG) + (size_t)t * NE;
    float gs[NG];
    for (int g = 0; g < NG; ++g) { float m1 = -1e30f, m2 = -1e30f;
        for (int i = 0; i < GSZ; ++i) { const int e = g * GSZ + i; const float v = 1.f / (1.f + expf(-lg[e])) + p.b_router[e]; if (v > m1) { m2 = m1; m1 = v; } else if (v > m2) m2 = v; }
        gs[g] = m1 + m2; }
    unsigned gmask = 0;
    for (int r = 0; r < TOPG; ++r) { int bi = -1; float bv = -1e30f; for (int g = 0; g < NG; ++g) if (!((gmask >> g) & 1) && gs[g] > bv) { bv = gs[g]; bi = g; } gmask |= 1u << bi; }
    int idx[TOPK]; float sc[TOPK]; float sum = 0.f;
    for (int r = 0; r < TOPK; ++r) { int bi = -1; float bv = -1e30f;
        for (int e = 0; e < NE; ++e) { if (!((gmask >> (e / GSZ)) & 1)) continue; bool used = false; for (int q = 0; q < r; ++q) used |= (idx[q] == e); if (used) continue;
            const float v = 1.f / (1.f + expf(-lg[e])) + p.b_router[e]; if (v > bv) { bv = v; bi = e; } }
        idx[r] = bi; sc[r] = 1.f / (1.f + expf(-lg[bi])); sum += sc[r]; }
    for (int r = 0; r < TOPK; ++r) { const int e = idx[r]; const int pos = atomicAdd(WSP(int, WS_CTL) + e, 1);
        WSP(int, WS_LTOK)[(size_t)e * LCAP + pos] = t * 8 + r; WSP(float, WS_WTS)[t * 8 + r] = sc[r] / sum * RSCALE; }
}
__global__ void k_scan(P p) { if (threadIdx.x == 0) { int a = 0; for (int e = 0; e < NE; ++e) { WSP(int, WS_BASE)[e] = a; a += WSP(int, WS_CTL)[e]; } WSP(int, WS_BASE)[NE] = a; } }
struct AL_gather { const bf16* H; const int* ltok; const int* cnt; __device__ int rows(int g) const { return cnt[g]; }
    __device__ float operator()(int g, int m, int k) const { const int tok = ltok[(size_t)g * LCAP + m] >> 3; return bf2f(H[(size_t)tok * D + k]); } };
struct BL_gu { const float *Wg, *Wu; __device__ float operator()(int g, int k, int n, int w) const { return (w ? Wu : Wg)[((size_t)g * D + k) * ED + n]; } };
struct EP_act { bf16* act; const int* base; const int* ltok; const float* wts;
    __device__ void operator()(int g, int m, int n, float a, float u) const { const int ts = ltok[(size_t)g * LCAP + m]; act[(size_t)(base[g] + m) * ED + n] = f2bf(silu(a) * u * wts[ts]); } };
struct AL_act { const bf16* act; const int* base; const int* cnt; __device__ int rows(int g) const { return cnt[g]; }
    __device__ float operator()(int g, int m, int k) const { return bf2f(act[(size_t)(base[g] + m) * ED + k]); } };
struct BL_down { const float* Wd; __device__ float operator()(int g, int k, int n, int) const { return Wd[((size_t)g * ED + k) * D + n]; } };
struct EP_y { bf16* Y; const int* ltok; __device__ void operator()(int g, int m, int n, float a, float) const { const int ts = ltok[(size_t)g * LCAP + m]; Y[(size_t)ts * D + n] = f2bf(a); } };
struct BL_shgu { const float *Wg, *Wu; __device__ float operator()(int, int k, int n, int w) const { return (w ? Wu : Wg)[(size_t)k * ED + n]; } };
struct EP_actsh { bf16* act; __device__ void operator()(int, int m, int n, float a, float u) const { act[(size_t)m * ED + n] = f2bf(silu(a) * u); } };
struct EP_f { float* F; const bf16* Y; __device__ void operator()(int, int m, int n, float a, float) const { float f = a; for (int k = 0; k < 8; ++k) f += bf2f(Y[((size_t)m * 8 + k) * D + n]); F[(size_t)m * D + n] = f; } };
__global__ void k_final(P p) {
    __shared__ float red[4];
    const int t = blockIdx.x, b = t / S; const float* f = WSP(float, WS_TMP) + (size_t)t * D; const float* mod = WSP(float, WS_MOD) + b * 6 * D;
    float v[4], ss = 0.f; for (int i = 0; i < 4; ++i) { v[i] = f[threadIdx.x + 256 * i]; ss += v[i] * v[i]; }
    ss = block_sum(ss, red); const float r = rsqrtf(ss / D + EPS);
    for (int i = 0; i < 4; ++i) { const int k = threadIdx.x + 256 * i; p.out[(size_t)t * D + k] += mod[5 * D + k] * (v[i] * r * p.g_post_ffn[k]); }
}

extern "C" void kernel_launch(void* const* d_in, const int* in_sizes, int n_in, void* d_out, int out_size, void* d_ws, size_t ws_size, hipStream_t stream) {
    if (n_in != 26 || ws_size < WS_END) { fprintf(stderr, "kernel_launch: unexpected n_in %d / ws %zu\n", n_in, ws_size); return; }
    P p{};
    p.x = (const float*)d_in[0]; p.c = (const float*)d_in[1]; p.pos = (const int*)d_in[2];
    const float** fp = &p.w_ada; for (int i = 3; i < 26; ++i) fp[i - 3] = (const float*)d_in[i];
    p.out = (float*)d_out; p.ws = (unsigned char*)d_ws;
    (void)hipMemsetAsync((char*)d_ws + WS_CTL, 0, 1 * MiB, stream);
    k_mod<<<dim3(6 * D / 256, NB), 256, 0, stream>>>(p);
    k_h1<<<T, 256, 0, stream>>>(p);
    ngemm<1><<<dim3((INP + 63) / 64, T / 64, 1), 256, 0, stream>>>(INP, D, AL_bf16{WSP(bf16, WS_H1), D, T}, BL_f32{p.w_in, INP, 0}, EP_z{WSP(bf16, WS_Z)});
    k_prep<<<T, 256, 0, stream>>>(p);
    ngemm<1><<<dim3(768 / 64, T / 64, 1), 256, 0, stream>>>(768, QL, AL_lat{WSP(bf16, WS_Z), p.g_q_lat, ZQ, 0}, BL_f32{p.w_uq, 768, 0}, EP_f32{WSP(float, WS_TMP), 768});
    k_qfin<<<T, 256, 0, stream>>>(p);
    ngemm<1><<<dim3(1024 / 64, T / 64, 1), 256, 0, stream>>>(1024, KVL, AL_lat{WSP(bf16, WS_Z), p.g_kv_lat, ZKV, 0}, BL_f32{p.w_ukv, 1024, 0}, EP_f32{WSP(float, WS_TMP), 1024});
    k_kvfin<<<T, 256, 0, stream>>>(p);
    k_attn<<<dim3(S / 64, NH, NB), 64, 0, stream>>>(p);
    ngemm<1><<<dim3(D / 64, T / 64, 1), 256, 0, stream>>>(D, D, AL_mix{WSP(bf16, WS_MIX), WSP(float, WS_SSA), p.g_attn_out}, BL_f32{p.w_out, D, 0}, EP_f32{WSP(float, WS_TMP), D});
    k_post<<<T, 256, 0, stream>>>(p);
    ngemm<1><<<dim3(NE / 64, T / 64, 1), 256, 0, stream>>>(NE, D, AL_h2full{WSP(bf16, WS_H2), WSP(bf16, WS_H2LO)}, BL_f32{p.w_router, NE, 0}, EP_f32{WSP(float, WS_LOG), NE});
    k_route<<<T / 256, 256, 0, stream>>>(p);
    k_scan<<<1, 64, 0, stream>>>(p);
    ngemm<2><<<dim3(ED / 64, T / 64, NE), 256, 0, stream>>>(ED, D, AL_gather{WSP(bf16, WS_H2), WSP(int, WS_LTOK), WSP(int, WS_CTL)}, BL_gu{p.w_gate, p.w_up},
                                                             EP_act{WSP(bf16, WS_ACT), WSP(int, WS_BASE), WSP(int, WS_LTOK), WSP(float, WS_WTS)});
    ngemm<1><<<dim3(D / 64, T / 64, NE), 256, 0, stream>>>(D, ED, AL_act{WSP(bf16, WS_ACT), WSP(int, WS_BASE), WSP(int, WS_CTL)}, BL_down{p.w_down}, EP_y{WSP(bf16, WS_Y), WSP(int, WS_LTOK)});
    ngemm<2><<<dim3(ED / 64, T / 64, 1), 256, 0, stream>>>(ED, D, AL_bf16{WSP(bf16, WS_H2), D, T}, BL_shgu{p.w_sh_gate, p.w_sh_up}, EP_actsh{WSP(bf16, WS_ACTSH)});
    ngemm<1><<<dim3(D / 64, T / 64, 1), 256, 0, stream>>>(D, ED, AL_bf16{WSP(bf16, WS_ACTSH), ED, T}, BL_f32{p.w_sh_down, D, 0}, EP_f{WSP(float, WS_TMP), WSP(bf16, WS_Y)});
    k_final<<<T, 256, 0, stream>>>(p);
}
```
